# Optimizing an MI355X kernel written in HIP

```python
import jax, jax.numpy as jnp
from jax import lax
import numpy as np

D_MODEL = 1024
BATCH = 8
SEQ = 4096
DEPTH = 1

N_META = 16
SWA_HEADS = 8
SWA_KV_HEADS = 2
SWA_HEAD_DIM = 64
SWA_WIDTH = SWA_HEADS * SWA_HEAD_DIM
SWA_KV_WIDTH = SWA_KV_HEADS * SWA_HEAD_DIM
WINDOW = 128
GLA_HEADS = 4
GLA_WIDTH = D_MODEL - SWA_WIDTH
GLA_V_DIM = GLA_WIDTH // GLA_HEADS
GLA_K_DIM = GLA_V_DIM // 2
GLA_K_WIDTH = GLA_HEADS * GLA_K_DIM
GLA_GATE_RANK = 16
GLA_TAU = 16.0
GLA_CHUNK = 64
D_FF = ((8 * D_MODEL + 3 * 256 - 1) // (3 * 256)) * 256
LN_EPS = 1e-5
RMS_EPS = 1e-6
ALPHA = (2.0 * DEPTH) ** 0.25
BETA = (8.0 * DEPTH) ** -0.25
IN_SPLITS = (SWA_WIDTH, SWA_KV_WIDTH, SWA_KV_WIDTH,
             GLA_K_WIDTH, GLA_K_WIDTH, GLA_WIDTH,
             GLA_WIDTH, GLA_GATE_RANK)
D_IN = int(sum(IN_SPLITS))
NEG_INF = -1e30

kernel_name = "hymba_gla_swa_sink_alibi_deepnorm"


def layer_norm(x, g, b):
    xf = x.astype(jnp.float32)
    mu = jnp.mean(xf, axis=-1, keepdims=True)
    var = jnp.mean(jnp.square(xf - mu), axis=-1, keepdims=True)
    y = (xf - mu) * lax.rsqrt(var + LN_EPS)
    return (y * g.astype(jnp.float32) + b.astype(jnp.float32)).astype(x.dtype)


def rms_norm(x, g):
    xf = x.astype(jnp.float32)
    y = xf * lax.rsqrt(jnp.mean(jnp.square(xf), axis=-1, keepdims=True) + RMS_EPS)
    return (y * g.astype(jnp.float32)).astype(x.dtype)


def alibi_slopes(n_heads):
    return jnp.asarray(2.0 ** (-8.0 * (np.arange(n_heads) + 1) / n_heads), dtype=jnp.float32)


def sink_softmax(scores, sink):
    sink = jnp.broadcast_to(sink, scores.shape[:-1] + (1,)).astype(jnp.float32)
    p = jax.nn.softmax(jnp.concatenate([scores, sink], axis=-1), axis=-1)
    return p[..., :-1]


def sliding_window_gqa(q, k, v, sinks):
    B, L, Hq, dh = q.shape
    Hkv = k.shape[2]
    G = Hq // Hkv
    S = L - N_META
    nb = S // WINDOW
    scale = dh ** -0.5
    slopes = alibi_slopes(Hq).reshape(Hkv, G)
    sink = sinks.astype(jnp.float32).reshape(Hkv, G)
    q = q.reshape(B, L, Hkv, G, dh)
    qm, qr = q[:, :N_META], q[:, N_META:]
    km, kr = k[:, :N_META], k[:, N_META:]
    vm, vr = v[:, :N_META], v[:, N_META:]

    qb = qr.reshape(B, nb, WINDOW, Hkv, G, dh)
    kb = kr.reshape(B, nb, WINDOW, Hkv, dh)
    vb = vr.reshape(B, nb, WINDOW, Hkv, dh)
    pad = ((0, 0), (1, 0), (0, 0), (0, 0), (0, 0))
    kband = jnp.concatenate([jnp.pad(kb, pad)[:, :-1], kb], axis=2)
    vband = jnp.concatenate([jnp.pad(vb, pad)[:, :-1], vb], axis=2)
    s_band = jnp.einsum('bnikgd,bnjkd->bkgnij', qb, kband).astype(jnp.float32) * scale
    s_meta = jnp.einsum('bnikgd,bmkd->bkgnim', qb, km).astype(jnp.float32) * scale
    qi = jnp.arange(nb)[:, None] * WINDOW + jnp.arange(WINDOW)[None, :]
    kj = jnp.arange(nb)[:, None] * WINDOW - WINDOW + jnp.arange(2 * WINDOW)[None, :]
    dist_band = qi[:, :, None] - kj[:, None, :]
    valid = (dist_band >= 0) & (dist_band < WINDOW) & (kj[:, None, :] >= 0)
    dist_meta = (qi + N_META)[:, :, None] - jnp.arange(N_META)[None, None, :]
    sl = slopes[:, :, None, None, None]
    s_band = jnp.where(valid, s_band - sl * dist_band.astype(jnp.float32), NEG_INF)
    s_meta = s_meta - sl * dist_meta.astype(jnp.float32)
    p = sink_softmax(jnp.concatenate([s_meta, s_band], axis=-1), sink[None, :, :, None, None, None])
    p = p.astype(v.dtype)
    o_real = (jnp.einsum('bkgnim,bmkd->bnikgd', p[..., :N_META], vm)
              + jnp.einsum('bkgnij,bnjkd->bnikgd', p[..., N_META:], vband))
    o_real = o_real.reshape(B, S, Hq * dh)

    s_mm = jnp.einsum('bikgd,bjkd->bkgij', qm, km).astype(jnp.float32) * scale
    dist_mm = jnp.arange(N_META)[:, None] - jnp.arange(N_META)[None, :]
    s_mm = jnp.where(dist_mm >= 0, s_mm - slopes[:, :, None, None] * dist_mm.astype(jnp.float32), NEG_INF)
    p_mm = sink_softmax(s_mm, sink[None, :, :, None, None]).astype(v.dtype)
    o_meta = jnp.einsum('bkgij,bjkd->bikgd', p_mm, vm).reshape(B, N_META, Hq * dh)
    return jnp.concatenate([o_meta, o_real], axis=1)


def chunked_gla(q, k, v, log_g):
    B, L, H, dk = q.shape
    dv = v.shape[-1]
    C = GLA_CHUNK
    pad_front = (-L) % C
    padw = ((0, 0), (pad_front, 0), (0, 0), (0, 0))
    q = jnp.pad(q * (dk ** -0.5), padw)
    k = jnp.pad(k, padw)
    v = jnp.pad(v, padw)
    log_g = jnp.pad(log_g, padw)
    Lp = L + pad_front
    n = Lp // C

    def to_chunks(t):
        return t.reshape(B, n, C, H, t.shape[-1]).transpose(1, 0, 3, 2, 4)

    qc, kc, vc = to_chunks(q), to_chunks(k), to_chunks(v)
    bc = jnp.cumsum(to_chunks(log_g).astype(jnp.float32), axis=3)
    causal = jnp.tril(jnp.ones((C, C), dtype=bool))[..., None]

    def step(state, inp):
        qx, kx, vx, bx = inp
        o_inter = jnp.einsum('bhcd,bhde->bhce', qx * jnp.exp(bx), state)
        diff = bx[:, :, :, None, :] - bx[:, :, None, :, :]
        decay = jnp.exp(jnp.where(causal, diff, NEG_INF))
        A = jnp.einsum('bhid,bhjd,bhijd->bhij', qx.astype(jnp.float32), kx.astype(jnp.float32), decay)
        o_intra = jnp.einsum('bhij,bhje->bhie', A, vx.astype(jnp.float32))
        b_last = bx[:, :, -1:, :]
        state = (jnp.exp(b_last[:, :, 0, :])[..., None] * state
                 + jnp.einsum('bhjd,bhje->bhde', kx * jnp.exp(b_last - bx), vx.astype(jnp.float32)))
        return state, o_inter + o_intra

    s0 = jnp.zeros((B, H, dk, dv), dtype=jnp.float32)
    _, o = lax.scan(step, s0, (qc, kc, vc, bc))
    o = o.transpose(1, 0, 3, 2, 4).reshape(B, Lp, H, dv)[:, pad_front:]
    return o.astype(v.dtype)


def hybrid_mixer(h, w_in, b_in, w_gate_lr2, b_gate_lr2, sinks, gla_norm_g, w_out):
    B, L, _ = h.shape
    proj = jnp.einsum('bld,de->ble', h, w_in) + b_in
    cuts = tuple(int(c) for c in np.cumsum(IN_SPLITS)[:-1])
    q_s, k_s, v_s, q_g, k_g, v_g, r_g, g_lr = jnp.split(proj, cuts, axis=-1)
    o_s = sliding_window_gqa(q_s.reshape(B, L, SWA_HEADS, SWA_HEAD_DIM),
                             k_s.reshape(B, L, SWA_KV_HEADS, SWA_HEAD_DIM),
                             v_s.reshape(B, L, SWA_KV_HEADS, SWA_HEAD_DIM), sinks)
    gate_logit = jnp.einsum('blr,rk->blk', g_lr, w_gate_lr2) + b_gate_lr2
    log_g = jax.nn.log_sigmoid(gate_logit.astype(jnp.float32)) / GLA_TAU
    o_g = chunked_gla(q_g.reshape(B, L, GLA_HEADS, GLA_K_DIM),
                      k_g.reshape(B, L, GLA_HEADS, GLA_K_DIM),
                      v_g.reshape(B, L, GLA_HEADS, GLA_V_DIM),
                      log_g.reshape(B, L, GLA_HEADS, GLA_K_DIM))
    o_g = rms_norm(o_g, gla_norm_g).reshape(B, L, GLA_WIDTH) * jax.nn.silu(r_g)
    o = jnp.concatenate([o_s, o_g], axis=-1)
    return jnp.einsum('ble,ed->bld', o, w_out)


def swiglu(h, w_gate, w_up, w_down):
    a = jax.nn.silu(jnp.einsum('bld,df->blf', h, w_gate)) * jnp.einsum('bld,df->blf', h, w_up)
    return jnp.einsum('blf,fd->bld', a, w_down)


def setup_inputs(seed: int = 0) -> dict:
    key = jax.random.key(seed)
    ks = jax.random.split(key, 20)
    f32 = jnp.float32
    nrm = lambda k, shape, s: jax.random.normal(k, shape, dtype=f32) * s
    col_scale = np.ones((D_IN,), dtype=np.float32)
    off = np.concatenate([[0], np.cumsum(IN_SPLITS)])
    col_scale[off[2]:off[3]] = BETA
    col_scale[off[5]:off[6]] = BETA
    return {
        "x": nrm(ks[0], (BATCH, SEQ, D_MODEL), 1.0),
        "meta_tokens": nrm(ks[1], (N_META, D_MODEL), 1.0),
        "ln_in_g": 1.0 + nrm(ks[2], (D_MODEL,), 0.02),
        "ln_in_b": nrm(ks[3], (D_MODEL,), 0.02),
        "w_in": nrm(ks[4], (DEPTH, D_MODEL, D_IN), D_MODEL ** -0.5) * jnp.asarray(col_scale),
        "b_in": nrm(ks[5], (DEPTH, D_IN), 0.02),
        "w_gate_lr2": nrm(ks[6], (DEPTH, GLA_GATE_RANK, GLA_K_WIDTH), GLA_GATE_RANK ** -0.5),
        "b_gate_lr2": nrm(ks[7], (DEPTH, GLA_K_WIDTH), 0.1),
        "attn_sinks": nrm(ks[8], (DEPTH, SWA_HEADS), 0.5),
        "gla_norm_g": 1.0 + nrm(ks[9], (DEPTH, GLA_V_DIM), 0.02),
        "w_out": nrm(ks[10], (DEPTH, D_MODEL, D_MODEL), BETA * D_MODEL ** -0.5),
        "ln1_g": 1.0 + nrm(ks[11], (DEPTH, D_MODEL), 0.02),
        "ln1_b": nrm(ks[12], (DEPTH, D_MODEL), 0.02),
        "w_ffn_gate": nrm(ks[13], (DEPTH, D_MODEL, D_FF), D_MODEL ** -0.5),
        "w_ffn_up": nrm(ks[14], (DEPTH, D_MODEL, D_FF), D_MODEL ** -0.5),
        "w_ffn_down": nrm(ks[15], (DEPTH, D_FF, D_MODEL), BETA * D_FF ** -0.5),
        "ln2_g": 1.0 + nrm(ks[16], (DEPTH, D_MODEL), 0.02),
        "ln2_b": nrm(ks[17], (DEPTH, D_MODEL), 0.02),
    }


def reference(x, meta_tokens, ln_in_g, ln_in_b, w_in, b_in, w_gate_lr2, b_gate_lr2,
              attn_sinks, gla_norm_g, w_out, ln1_g, ln1_b, w_ffn_gate, w_ffn_up,
              w_ffn_down, ln2_g, ln2_b):
    B = x.shape[0]
    meta = jnp.broadcast_to(meta_tokens[None].astype(x.dtype), (B, N_META, x.shape[-1]))
    h = layer_norm(jnp.concatenate([meta, x], axis=1), ln_in_g, ln_in_b)
    for l in range(DEPTH):
        mix = hybrid_mixer(h, w_in[l], b_in[l], w_gate_lr2[l], b_gate_lr2[l],
                           attn_sinks[l], gla_norm_g[l], w_out[l])
        h = layer_norm(ALPHA * h + mix, ln1_g[l], ln1_b[l])
        ffn = swiglu(h, w_ffn_gate[l], w_ffn_up[l], w_ffn_down[l])
        h = layer_norm(ALPHA * h + ffn, ln2_g[l], ln2_b[l])
    return h[:, N_META:]
```

```cpp
#include <hip/hip_runtime.h>
#include <cstdio>
#include <cstdint>

typedef unsigned short bf16;
typedef short bf16x8 __attribute__((ext_vector_type(8)));
typedef float f32x4 __attribute__((ext_vector_type(4)));

constexpr int D = 1024, BATCH = 8, SEQ = 4096, NMETA = 16, M = BATCH * SEQ;
constexpr int DIN = 2320, DINP = 2560, DFF = 2816;
constexpr int C_QS = 0, C_KS = 512, C_VS = 640, C_QG = 768, C_KG = 1024, C_VG = 1280, C_RG = 1792, C_LR = 2304;
constexpr float LN_EPS = 1e-5f, RMS_EPS = 1e-6f, ALPHA = 1.189207115002721f;
constexpr size_t MiB = 1u << 20;
constexpr size_t WS_WIN = 2 * MiB, WS_WOUT = 7 * MiB, WS_WGU = 9 * MiB, WS_WDN = 20 * MiB, WS_XMETA = 28 * MiB, WS_PMETA = 28 * MiB + 256 * 1024;
constexpr size_t WS_XN = 48 * MiB, WS_H1 = 112 * MiB, WS_PROJ = 176 * MiB, WS_OMIX = 336 * MiB, WS_HB = 176 * MiB;
constexpr size_t WS_Y1 = 176 * MiB, WS_Y2 = 352 * MiB, WS_GK = 400 * MiB, WS_OG = 434 * MiB, WS_END = 498 * MiB;

__device__ __forceinline__ unsigned f2bf(float f) { unsigned u = __builtin_bit_cast(unsigned, f); return (u + 0x7fffu + ((u >> 16) & 1u)) >> 16; }
__device__ __forceinline__ float bf2f(bf16 h) { return __builtin_bit_cast(float, (unsigned)h << 16); }
__device__ __forceinline__ float wave_sum(float v) {
#pragma unroll
    for (int o = 1; o < 64; o <<= 1) v += __shfl_xor(v, o);
    return v;
}

__global__ void __launch_bounds__(256) k_ln_in(const float* x, const float* meta, const float* g, const float* b, bf16* XN, float* XMETA) {
    const int lane = threadIdx.x & 63, row = blockIdx.x * 4 + (threadIdx.x >> 6);
    if (row >= M + NMETA) return;
    const float* src = row < M ? x + (size_t)row * D : meta + (size_t)(row - M) * D;
    float v[16]; float s = 0.f;
#pragma unroll
    for (int j = 0; j < 4; ++j) { const f32x4 t = *(const f32x4*)(src + j * 256 + lane * 4); v[4 * j] = t.x; v[4 * j + 1] = t.y; v[4 * j + 2] = t.z; v[4 * j + 3] = t.w; s += (t.x + t.y) + (t.z + t.w); }
    const float mean = wave_sum(s) * (1.f / D); float q = 0.f;
#pragma unroll
    for (int i = 0; i < 16; ++i) { v[i] -= mean; q += v[i] * v[i]; }
    const float rstd = 1.f / sqrtf(wave_sum(q) * (1.f / D) + LN_EPS);
#pragma unroll
    for (int j = 0; j < 4; ++j)
#pragma unroll
        for (int i = 0; i < 4; ++i) { const int c = j * 256 + lane * 4 + i; const float y = v[4 * j + i] * rstd * g[c] + b[c];
            if (row < M) XN[(size_t)row * D + c] = (bf16)f2bf(y); else XMETA[(size_t)(row - M) * D + c] = y; }
}
__global__ void __launch_bounds__(256) k_meta_proj(const float* XMETA, const float* w_in, const float* b_in, float* PMETA) {
    const int idx = blockIdx.x * 256 + threadIdx.x; if (idx >= NMETA * DIN) return;
    const int m = idx / DIN, n = idx % DIN; float acc = 0.f;
    for (int k = 0; k < D; ++k) acc = fmaf(XMETA[m * D + k], w_in[(size_t)k * DIN + n], acc);
    PMETA[idx] = acc + b_in[n];
}
__global__ void __launch_bounds__(256) k_convert_w(const float* W0, const float* W1, int K, int N, int Nout, int mode, bf16* WT) {
    const size_t idx = (size_t)blockIdx.x * 256 + threadIdx.x; if (idx >= (size_t)Nout * K) return;
    const int r = (int)(idx / K), k = (int)(idx % K); float v = 0.f;
    if (mode == 0) { if (r < N) v = W0[(size_t)k * N + r]; }
    else { const int tile = r >> 8, j = r & 255; v = (j < 128) ? W0[(size_t)k * N + tile * 128 + j] : W1[(size_t)k * N + tile * 128 + j - 128]; }
    WT[idx] = (bf16)f2bf(v);
}
template <int MODE> __global__ void __launch_bounds__(256) k_gemm(const bf16* A, const bf16* Bt, int K, void* Cout, int ldc, const float* bias, int ncols_valid) {
    const int lane = threadIdx.x & 63, wave = threadIdx.x >> 6, fr = lane & 15, fq = lane >> 4;
    const int row0 = blockIdx.y * 64 + wave * 16;
    int brow[4];
#pragma unroll
    for (int s = 0; s < 4; ++s) {
        if (MODE == 2) { const int f0 = blockIdx.x * 32 + (s & 1) * 16; const int tile = f0 >> 7, j = f0 & 127; brow[s] = tile * 256 + (s >> 1) * 128 + j; }
        else brow[s] = blockIdx.x * 64 + s * 16;
    }
    f32x4 acc[4];
#pragma unroll
    for (int s = 0; s < 4; ++s) acc[s] = (f32x4){0.f, 0.f, 0.f, 0.f};
    const bf16* ap = A + (size_t)(row0 + fr) * K + fq * 8;
    for (int k0 = 0; k0 < K; k0 += 32) {
        const bf16x8 a = *(const bf16x8*)(ap + k0);
#pragma unroll
        for (int s = 0; s < 4; ++s) { const bf16x8 b = *(const bf16x8*)(Bt + (size_t)(brow[s] + fr) * K + k0 + fq * 8); acc[s] = __builtin_amdgcn_mfma_f32_16x16x32_bf16(a, b, acc[s], 0, 0, 0); }
    }
#pragma unroll
    for (int j = 0; j < 4; ++j) { const int row = row0 + fq * 4 + j;
        if (MODE == 0) {
#pragma unroll
            for (int s = 0; s < 4; ++s) { const int col = blockIdx.x * 64 + s * 16 + fr; if (col < ncols_valid) ((bf16*)Cout)[(size_t)row * ldc + col] = (bf16)f2bf(acc[s][j] + bias[col]); }
        } else if (MODE == 1) {
#pragma unroll
            for (int s = 0; s < 4; ++s) { const int col = blockIdx.x * 64 + s * 16 + fr; ((float*)Cout)[(size_t)row * ldc + col] = acc[s][j]; }
        } else {
#pragma unroll
            for (int s = 0; s < 2; ++s) { const int f = blockIdx.x * 32 + s * 16 + fr; const float gt = acc[s][j], up = acc[s + 2][j]; const float sl = gt / (1.f + __expf(-gt));
                ((bf16*)Cout)[(size_t)row * ldc + f] = (bf16)f2bf(sl * up); }
        }
    }
}
__global__ void __launch_bounds__(256) k_gate(const bf16* PROJ, const float* PMETA, const float* w2, const float* b2, float* GK) {
    const int row = blockIdx.x, c = threadIdx.x; float lr[16];
#pragma unroll
    for (int r = 0; r < 16; ++r) lr[r] = row < NMETA ? PMETA[row * DIN + C_LR + r] : bf2f(PROJ[(size_t)(row - NMETA) * DINP + C_LR + r]);
    float x = b2[c];
#pragma unroll
    for (int r = 0; r < 16; ++r) x = fmaf(lr[r], w2[r * 256 + c], x);
    const float ls = fminf(x, 0.f) - log1pf(expf(-fabsf(x)));
    GK[(size_t)row * 256 + c] = ls * (1.f / 16.f);
}
__global__ void __launch_bounds__(128) k_gla(const bf16* PROJ, const float* PMETA, const float* GK, float* OG) {
    const int b = blockIdx.x >> 2, h = blockIdx.x & 3, e = threadIdx.x;
    float S[64];
#pragma unroll
    for (int d = 0; d < 64; ++d) S[d] = 0.f;
    for (int t = 0; t < NMETA; ++t) {
        const float v = PMETA[t * DIN + C_VG + h * 128 + e];
#pragma unroll
        for (int d = 0; d < 64; ++d) { const float a = __expf(GK[(size_t)t * 256 + h * 64 + d]); S[d] = fmaf(a, S[d], PMETA[t * DIN + C_KG + h * 64 + d] * v); }
    }
    for (int t = 0; t < SEQ; ++t) {
        const size_t row = (size_t)b * SEQ + t; const bf16* pr = PROJ + row * DINP; const float* gk = GK + (row + NMETA) * 256 + h * 64;
        const float v = bf2f(pr[C_VG + h * 128 + e]); float o = 0.f;
#pragma unroll
        for (int d = 0; d < 64; ++d) { const float a = __expf(gk[d]); S[d] = fmaf(a, S[d], bf2f(pr[C_KG + h * 64 + d]) * v); o = fmaf(bf2f(pr[C_QG + h * 64 + d]) * 0.125f, S[d], o); }
        OG[row * 512 + h * 128 + e] = o;
    }
}
__global__ void __launch_bounds__(256) k_gla_post(const float* OG, const bf16* PROJ, const float* ng, bf16* OMIX) {
    const int lane = threadIdx.x & 63; const size_t item = (size_t)blockIdx.x * 4 + (threadIdx.x >> 6); const size_t row = item >> 2; const int h = (int)(item & 3);
    const float o0 = OG[row * 512 + h * 128 + lane], o1 = OG[row * 512 + h * 128 + 64 + lane];
    const float ms = wave_sum(o0 * o0 + o1 * o1) * (1.f / 128.f); const float r = 1.f / sqrtf(ms + RMS_EPS);
    const float r0 = bf2f(PROJ[row * DINP + C_RG + h * 128 + lane]), r1 = bf2f(PROJ[row * DINP + C_RG + h * 128 + 64 + lane]);
    OMIX[row * D + 512 + h * 128 + lane] = (bf16)f2bf(o0 * r * ng[lane] * (r0 / (1.f + __expf(-r0))));
    OMIX[row * D + 512 + h * 128 + 64 + lane] = (bf16)f2bf(o1 * r * ng[64 + lane] * (r1 / (1.f + __expf(-r1))));
}
__global__ void __launch_bounds__(64) k_swa(const bf16* PROJ, const float* PMETA, const float* sinks, bf16* OMIX) {
    const int idx = blockIdx.x * 64 + threadIdx.x; const int t = idx % SEQ, h = (idx / SEQ) % 8, b = idx / (SEQ * 8); const int kv = h >> 2;
    const float slope = exp2f(-(float)(h + 1)); const size_t row = (size_t)b * SEQ + t;
    float q[64], acc[64];
#pragma unroll
    for (int d = 0; d < 64; ++d) { q[d] = bf2f(PROJ[row * DINP + C_QS + h * 64 + d]) * 0.125f; acc[d] = 0.f; }
    float m = sinks[h], l = 1.f;
    for (int j = 0; j < NMETA; ++j) {
        float s = 0.f;
#pragma unroll
        for (int d = 0; d < 64; ++d) s = fmaf(q[d], PMETA[j * DIN + C_KS + kv * 64 + d], s);
        s -= slope * (float)(t + NMETA - j);
        const float mn = fmaxf(m, s), f = __expf(m - mn), p = __expf(s - mn); l = l * f + p; m = mn;
#pragma unroll
        for (int d = 0; d < 64; ++d) acc[d] = fmaf(acc[d], f, p * PMETA[j * DIN + C_VS + kv * 64 + d]);
    }
    const int j0 = t - 127 < 0 ? 0 : t - 127;
    for (int j = j0; j <= t; ++j) {
        const bf16* kr = PROJ + ((size_t)b * SEQ + j) * DINP; float s = 0.f;
#pragma unroll
        for (int d = 0; d < 64; ++d) s = fmaf(q[d], bf2f(kr[C_KS + kv * 64 + d]), s);
        s -= slope * (float)(t - j);
        const float mn = fmaxf(m, s), f = __expf(m - mn), p = __expf(s - mn); l = l * f + p; m = mn;
#pragma unroll
        for (int d = 0; d < 64; ++d) acc[d] = fmaf(acc[d], f, p * bf2f(kr[C_VS + kv * 64 + d]));
    }
    const float il = 1.f / l;
#pragma unroll
    for (int d = 0; d < 64; ++d) OMIX[row * D + h * 64 + d] = (bf16)f2bf(acc[d] * il);
}
template <bool OUTBF> __global__ void __launch_bounds__(256) k_ln_res(const bf16* base, const float* Y, const float* g, const float* b, void* out) {
    const int lane = threadIdx.x & 63; const size_t row = (size_t)blockIdx.x * 4 + (threadIdx.x >> 6);
    float v[16]; float s = 0.f;
#pragma unroll
    for (int j = 0; j < 4; ++j)
#pragma unroll
        for (int i = 0; i < 4; ++i) { const int c = j * 256 + lane * 4 + i; v[4 * j + i] = ALPHA * bf2f(base[row * D + c]) + Y[row * D + c]; s += v[4 * j + i]; }
    const float mean = wave_sum(s) * (1.f / D); float q = 0.f;
#pragma unroll
    for (int i = 0; i < 16; ++i) { v[i] -= mean; q += v[i] * v[i]; }
    const float rstd = 1.f / sqrtf(wave_sum(q) * (1.f / D) + LN_EPS);
#pragma unroll
    for (int j = 0; j < 4; ++j)
#pragma unroll
        for (int i = 0; i < 4; ++i) { const int c = j * 256 + lane * 4 + i; const float y = v[4 * j + i] * rstd * g[c] + b[c];
            if (OUTBF) ((bf16*)out)[row * D + c] = (bf16)f2bf(y); else ((float*)out)[row * D + c] = y; }
}

extern "C" void kernel_launch(void* const* d_in, const int* in_sizes, int n_in, void* d_out, int out_size, void* d_ws, size_t ws_size, hipStream_t stream) {
    if (n_in != 18 || ws_size < WS_END || out_size != M * D) { fprintf(stderr, "kernel_launch: unexpected shapes (n_in %d, ws %zu, out %d)\n", n_in, ws_size, out_size); return; }
    const float* x = (const float*)d_in[0]; const float* meta = (const float*)d_in[1]; const float* ln_in_g = (const float*)d_in[2]; const float* ln_in_b = (const float*)d_in[3];
    const float* w_in = (const float*)d_in[4]; const float* b_in = (const float*)d_in[5]; const float* w2 = (const float*)d_in[6]; const float* b2 = (const float*)d_in[7];
    const float* sinks = (const float*)d_in[8]; const float* gng = (const float*)d_in[9]; const float* w_out = (const float*)d_in[10];
    const float* ln1_g = (const float*)d_in[11]; const float* ln1_b = (const float*)d_in[12]; const float* w_g = (const float*)d_in[13]; const float* w_u = (const float*)d_in[14];
    const float* w_d = (const float*)d_in[15]; const float* ln2_g = (const float*)d_in[16]; const float* ln2_b = (const float*)d_in[17];
    unsigned char* ws = (unsigned char*)d_ws;
    bf16* WIN = (bf16*)(ws + WS_WIN); bf16* WOUT = (bf16*)(ws + WS_WOUT); bf16* WGU = (bf16*)(ws + WS_WGU); bf16* WDN = (bf16*)(ws + WS_WDN);
    float* XMETA = (float*)(ws + WS_XMETA); float* PMETA = (float*)(ws + WS_PMETA);
    bf16* XN = (bf16*)(ws + WS_XN); bf16* H1 = (bf16*)(ws + WS_H1); bf16* PROJ = (bf16*)(ws + WS_PROJ); bf16* OMIX = (bf16*)(ws + WS_OMIX); bf16* HB = (bf16*)(ws + WS_HB);
    float* Y1 = (float*)(ws + WS_Y1); float* Y2 = (float*)(ws + WS_Y2); float* GK = (float*)(ws + WS_GK); float* OG = (float*)(ws + WS_OG);

    k_ln_in<<<(M + NMETA) / 4, 256, 0, stream>>>(x, meta, ln_in_g, ln_in_b, XN, XMETA);
    k_meta_proj<<<(NMETA * DIN + 255) / 256, 256, 0, stream>>>(XMETA, w_in, b_in, PMETA);
    k_convert_w<<<(unsigned)(((size_t)DINP * D + 255) / 256), 256, 0, stream>>>(w_in, nullptr, D, DIN, DINP, 0, WIN);
    k_convert_w<<<(unsigned)(((size_t)D * D + 255) / 256), 256, 0, stream>>>(w_out, nullptr, D, D, D, 0, WOUT);
    k_convert_w<<<(unsigned)(((size_t)2 * DFF * D + 255) / 256), 256, 0, stream>>>(w_g, w_u, D, DFF, 2 * DFF, 1, WGU);
    k_convert_w<<<(unsigned)(((size_t)D * DFF + 255) / 256), 256, 0, stream>>>(w_d, nullptr, DFF, D, D, 0, WDN);
    k_gemm<0><<<dim3(DINP / 64, M / 64), 256, 0, stream>>>(XN, WIN, D, PROJ, DINP, b_in, DIN);
    k_gate<<<M + NMETA, 256, 0, stream>>>(PROJ, PMETA, w2, b2, GK);
    k_gla<<<BATCH * 4, 128, 0, stream>>>(PROJ, PMETA, GK, OG);
    k_gla_post<<<M, 256, 0, stream>>>(OG, PROJ, gng, OMIX);
    k_swa<<<BATCH * 8 * SEQ / 64, 64, 0, stream>>>(PROJ, PMETA, sinks, OMIX);
    k_gemm<1><<<dim3(D / 64, M / 64), 256, 0, stream>>>(OMIX, WOUT, D, Y1, D, nullptr, D);
    k_ln_res<true><<<M / 4, 256, 0, stream>>>(XN, Y1, ln1_g, ln1_b, H1);
    k_gemm<2><<<dim3(DFF / 32, M / 64), 256, 0, stream>>>(H1, WGU, D, HB, DFF, nullptr, DFF);
    k_gemm<1><<<dim3(D / 64, M / 64), 256, 0, stream>>>(HB, WDN, DFF, Y2, D, nullptr, D);
    k_ln_res<false><<<M / 4, 256, 0, stream>>>(H1, Y2, ln2_g, ln2_b, d_out);
}
```
